# Optimizing an MI355X kernel written in HIP

```python
import jax, jax.numpy as jnp
from jax import lax
import numpy as np

D_MODEL = 1024
BATCH = 2
SEQ = 8192
DEPTH = 1

MIX_WIDTH = D_MODEL
CONV_WIDTH = D_MODEL // 2
CONV_GROUPS = 8
CONV_GROUP_DIM = CONV_WIDTH // CONV_GROUPS
CONV_KSIZE = 31
GMLP_WIDTH = MIX_WIDTH - CONV_WIDTH
GMLP_HEADS = 8
GMLP_HEAD_DIM = GMLP_WIDTH // GMLP_HEADS
CHUNK = 128
N_GROUPS = 4
EXPERTS_PER_GROUP = 8
N_EXPERTS = N_GROUPS * EXPERTS_PER_GROUP
TOP_K_INNER = 2
D_EXPERT = D_MODEL // 4
N_MOD = 6
EPS = 1e-6

kernel_name = "hybrid_conv_gmlp_hmoe_block"


def rms_norm(x, g):
    xf = x.astype(jnp.float32)
    y = xf * lax.rsqrt(jnp.mean(xf * xf, axis=-1, keepdims=True) + EPS)
    return (y * g.astype(jnp.float32)).astype(x.dtype)


def layer_norm(x, g, b):
    xf = x.astype(jnp.float32)
    mu = jnp.mean(xf, axis=-1, keepdims=True)
    var = jnp.mean(jnp.square(xf - mu), axis=-1, keepdims=True)
    y = (xf - mu) * lax.rsqrt(var + EPS)
    return (y * g.astype(jnp.float32) + b.astype(jnp.float32)).astype(x.dtype)


def modulate(h, shift, scale):
    return h * (1 + scale[:, None, :]) + shift[:, None, :]


def conv_module(z, w_dw, b_dw, ln_g, ln_b):
    a, g = jnp.split(z, 2, axis=-1)
    y = a * jax.nn.sigmoid(g)
    y = lax.conv_general_dilated(
        y, w_dw[:, None, :].astype(y.dtype), window_strides=(1,),
        padding=((CONV_KSIZE - 1, 0),),
        dimension_numbers=("NWC", "WIO", "NWC"),
        feature_group_count=CONV_WIDTH) + b_dw
    B, S, _ = y.shape
    y = layer_norm(y.reshape(B, S, CONV_GROUPS, CONV_GROUP_DIM), ln_g, ln_b)
    return jax.nn.silu(y.reshape(B, S, CONV_WIDTH))


def chunked_sgu(z, ln_g, ln_b, w_s, b_s):
    u, v = jnp.split(jax.nn.gelu(z), 2, axis=-1)
    B, S, _ = u.shape
    v = v.reshape(B, S // CHUNK, CHUNK, GMLP_HEADS, GMLP_HEAD_DIM)
    v = layer_norm(v, ln_g, ln_b)
    w = w_s * jnp.tril(jnp.ones((CHUNK, CHUNK), dtype=w_s.dtype))
    mixed = jnp.einsum("hts,bcshd->bcthd", w, v) + b_s.T[None, None, :, :, None]
    return u * mixed.reshape(B, S, GMLP_WIDTH)


def hier_moe(h, w_coarse, b_coarse, w_fine, b_fine, w_gate, w_up, w_down):
    B, S, D = h.shape
    t = h.reshape(B * S, D)
    coarse_p = jax.nn.softmax((t @ w_coarse + b_coarse).astype(jnp.float32), axis=-1)
    grp = jnp.argmax(coarse_p, axis=-1)
    p_grp = jnp.max(coarse_p, axis=-1)
    fine_logits = (jnp.einsum("td,gde->tge", t, w_fine) + b_fine).astype(jnp.float32)
    fine_sel = jnp.take_along_axis(fine_logits, grp[:, None, None], axis=1)[:, 0]
    fine_p = jax.nn.softmax(fine_sel, axis=-1)
    top_v, top_i = lax.top_k(fine_p, TOP_K_INNER)
    top_v = top_v / jnp.sum(top_v, axis=-1, keepdims=True)
    inner = jnp.sum(jax.nn.one_hot(top_i, EXPERTS_PER_GROUP, dtype=jnp.float32) * top_v[..., None], axis=1)
    gates = (jax.nn.one_hot(grp, N_GROUPS, dtype=jnp.float32)[:, :, None]
             * (p_grp[:, None, None] * inner[:, None, :])).reshape(B * S, N_EXPERTS).astype(h.dtype)
    y = jnp.zeros_like(t)
    for e in range(N_EXPERTS):
        hid = jax.nn.silu(t @ w_gate[e]) * (t @ w_up[e])
        y = y + gates[:, e:e + 1] * (hid @ w_down[e])
    return y.reshape(B, S, D)


def setup_inputs(seed: int = 0) -> dict:
    key = jax.random.key(seed)
    ks = jax.random.split(key, 24)
    f32 = jnp.float32
    L, D = DEPTH, D_MODEL
    n = lambda k, shape, s: jax.random.normal(k, shape, f32) * s
    return {
        "x": n(ks[0], (BATCH, SEQ, D), 1.0),
        "c": n(ks[1], (BATCH, D), 1.0),
        "w_ada": n(ks[2], (L, D, N_MOD * D), 0.5 * D ** -0.5),
        "b_ada": n(ks[3], (L, N_MOD * D), 0.01),
        "g_mix": 1.0 + n(ks[4], (L, D), 0.02),
        "w_in": n(ks[5], (L, D, 2 * MIX_WIDTH), D ** -0.5),
        "conv_w": n(ks[6], (L, CONV_KSIZE, CONV_WIDTH), CONV_KSIZE ** -0.5),
        "conv_b": n(ks[7], (L, CONV_WIDTH), 0.01),
        "conv_ln_g": 1.0 + n(ks[8], (L, CONV_GROUPS, CONV_GROUP_DIM), 0.02),
        "conv_ln_b": n(ks[9], (L, CONV_GROUPS, CONV_GROUP_DIM), 0.01),
        "sgu_ln_g": 1.0 + n(ks[10], (L, GMLP_HEADS, GMLP_HEAD_DIM), 0.02),
        "sgu_ln_b": n(ks[11], (L, GMLP_HEADS, GMLP_HEAD_DIM), 0.01),
        "sgu_w": n(ks[12], (L, GMLP_HEADS, CHUNK, CHUNK), CHUNK ** -0.5),
        "sgu_b": 1.0 + n(ks[13], (L, GMLP_HEADS, CHUNK), 0.1),
        "w_out": n(ks[14], (L, MIX_WIDTH, D), MIX_WIDTH ** -0.5),
        "g_ffn": 1.0 + n(ks[15], (L, D), 0.02),
        "w_coarse": n(ks[16], (L, D, N_GROUPS), D ** -0.5),
        "b_coarse": n(ks[17], (L, N_GROUPS), 0.01),
        "w_fine": n(ks[18], (L, N_GROUPS, D, EXPERTS_PER_GROUP), D ** -0.5),
        "b_fine": n(ks[19], (L, N_GROUPS, EXPERTS_PER_GROUP), 0.01),
        "w_gate": n(ks[20], (L, N_EXPERTS, D, D_EXPERT), D ** -0.5),
        "w_up": n(ks[21], (L, N_EXPERTS, D, D_EXPERT), D ** -0.5),
        "w_down": n(ks[22], (L, N_EXPERTS, D_EXPERT, D), D_EXPERT ** -0.5),
        "g_final": 1.0 + n(ks[23], (D,), 0.02),
    }


def reference(x, c, w_ada, b_ada, g_mix, w_in, conv_w, conv_b, conv_ln_g, conv_ln_b,
              sgu_ln_g, sgu_ln_b, sgu_w, sgu_b, w_out, g_ffn, w_coarse, b_coarse,
              w_fine, b_fine, w_gate, w_up, w_down, g_final):
    c_act = jax.nn.silu(c)
    for l in range(DEPTH):
        mod = c_act @ w_ada[l] + b_ada[l]
        sh1, sc1, gt1, sh2, sc2, gt2 = jnp.split(mod, N_MOD, axis=-1)
        h = modulate(rms_norm(x, g_mix[l]), sh1, sc1)
        z = h @ w_in[l]
        z_conv = z[..., :2 * CONV_WIDTH]
        z_sgu = z[..., 2 * CONV_WIDTH:]
        y_conv = conv_module(z_conv, conv_w[l], conv_b[l], conv_ln_g[l], conv_ln_b[l])
        y_sgu = chunked_sgu(z_sgu, sgu_ln_g[l], sgu_ln_b[l], sgu_w[l], sgu_b[l])
        mix = jnp.concatenate([y_conv, y_sgu], axis=-1) @ w_out[l]
        x = x + gt1[:, None, :] * mix
        h = modulate(rms_norm(x, g_ffn[l]), sh2, sc2)
        x = x + gt2[:, None, :] * hier_moe(h, w_coarse[l], b_coarse[l], w_fine[l], b_fine[l],
                                           w_gate[l], w_up[l], w_down[l])
    return rms_norm(x, g_final)
```

```cpp
#include <hip/hip_runtime.h>
#include <cstdio>
#include <cstdint>

#ifndef NAIVE_GEMM
#define NAIVE_GEMM 0
#endif

#define LAS __attribute__((address_space(3)))
#define GAS __attribute__((address_space(1)))
typedef unsigned short bf16_t;
typedef short bf16x8 __attribute__((ext_vector_type(8)));
typedef float f32x4 __attribute__((ext_vector_type(4)));
typedef float f32x2 __attribute__((ext_vector_type(2)));
typedef unsigned u32x4 __attribute__((ext_vector_type(4)));
typedef unsigned u32x2 __attribute__((ext_vector_type(2)));
#define RLX_AGENT __ATOMIC_RELAXED, __HIP_MEMORY_SCOPE_AGENT
#define LDS_WAIT() asm volatile("s_waitcnt lgkmcnt(0)" ::: "memory")
#define VM_WAIT() asm volatile("s_waitcnt vmcnt(0)" ::: "memory")

constexpr int T = 16384, D = 1024, SEQ = 8192, NMOD = 6144, NEXP = 32, DEXP = 256;
constexpr float EPS = 1e-6f;
constexpr int NWAVES = 8;

constexpr size_t MiB = 1u << 20;
constexpr size_t WS_CTL = 0, CTL_ZERO_BYTES = 65536;
constexpr size_t WS_MODP = 1 * MiB;
constexpr size_t WS_MODF = 2 * MiB + 512 * 1024;
constexpr size_t WS_WR = 2 * MiB + 768 * 1024;
constexpr size_t WS_SUMSQ = 3 * MiB;
constexpr size_t WS_ROUTE = 4 * MiB;
constexpr size_t WS_SGUW = 4 * MiB + 512 * 1024;
constexpr size_t WS_TOKL = 5 * MiB;
constexpr size_t WS_GATEL = 7 * MiB;
constexpr size_t WS_WIN = 10 * MiB;
constexpr size_t WS_WOUT = 14 * MiB;
constexpr size_t WS_WGU = 16 * MiB;
constexpr size_t WS_WD = 48 * MiB;
constexpr size_t WS_H = 64 * MiB;
constexpr size_t WS_YGLU = 96 * MiB;
constexpr size_t WS_UG = 112 * MiB;
constexpr size_t WS_VLN = 128 * MiB;
constexpr size_t WS_YMIX = 144 * MiB;
constexpr size_t WS_HID = 176 * MiB;
constexpr size_t WS_YPAIR = 96 * MiB;
constexpr size_t WS_END = 196 * MiB;
constexpr int CW_BAR = 1024;
constexpr int CW_ECNT = 8192;

constexpr int RING_BYTES = 131072;
constexpr int LDSCTL_OFF = 139264;
constexpr int LDS_BYTES = 147456;
constexpr int LC_BAR = 0, LC_ECNT = 64, LC_TBASE = 256;

__device__ __forceinline__ float bf2f(unsigned b) { return __uint_as_float(b << 16); }
__device__ __forceinline__ unsigned f2bf(float f) { unsigned u = __float_as_uint(f); return (u + 0x7fffu + ((u >> 16) & 1u)) >> 16; }
__device__ __forceinline__ unsigned pk2(float lo, float hi) { unsigned r; asm volatile("v_cvt_pk_bf16_f32 %0, %1, %2" : "=v"(r) : "v"(lo), "v"(hi)); return r; }
__device__ __forceinline__ float fexp2(float x) { return __builtin_amdgcn_exp2f(x); }
__device__ __forceinline__ float frcp(float x) { return __builtin_amdgcn_rcpf(x); }
__device__ __forceinline__ float frsq(float x) { return __builtin_amdgcn_rsqf(x); }
__device__ __forceinline__ float sigmoid_(float x) { return frcp(1.0f + fexp2(-1.4426950408889634f * x)); }
__device__ __forceinline__ float silu_(float x) { return x * sigmoid_(x); }
__device__ __forceinline__ float gelu_tanh_(float x) { const float u = 0.7978845608028654f * (x + 0.044715f * x * x * x); return x * sigmoid_(2.0f * u); }
__device__ __forceinline__ float wave_sum(float v) {
#pragma unroll
    for (int o = 1; o < 64; o <<= 1) v += __shfl_xor(v, o);
    return v;
}

#define XB_TMO      128
#define XB_XCNT(j)  (256  + 64 * (j))
#define XB_XSUB(j)  (1280 + 64 * (j))
#define XB_XGEN(j)  (2304 + 64 * (j))
#define XB_TOP      3328
#define XB_TOPGEN   3392
#define XCD_BAR_WORDS 3456
#define XB_SPIN_CAP (1u << 18)
__device__ __forceinline__ unsigned xb_ld(unsigned* p)              { return __hip_atomic_load(p, __ATOMIC_RELAXED, __HIP_MEMORY_SCOPE_AGENT); }
__device__ __forceinline__ unsigned xb_add(unsigned* p, unsigned v) { return __hip_atomic_fetch_add(p, v, __ATOMIC_RELAXED, __HIP_MEMORY_SCOPE_AGENT); }
__device__ __forceinline__ unsigned xb_xcc_id() { return (unsigned)__builtin_amdgcn_s_getreg((3 << 11) | 20) & 0xFu; }
#define XB_SPIN(cond, bar) do { unsigned _sp = 0; while (cond) { __builtin_amdgcn_s_sleep(1); \
    if ((++_sp & 255u) == 0u) { if (xb_ld(&(bar)[XB_TMO])) break; if (_sp > XB_SPIN_CAP) { atomicAdd(&(bar)[XB_TMO], 1u); break; } } } } while (0)
struct XcdBarrier { unsigned* bar; unsigned x; volatile LAS unsigned* st; };
__device__ __forceinline__ XcdBarrier xcd_barrier_post(unsigned* bar, volatile LAS unsigned* st) {
    XcdBarrier b; b.bar = bar; b.x = xb_xcc_id(); b.st = st;
    if (threadIdx.x == 0) (void)xb_add(&bar[XB_XCNT(b.x)], 1u);
    return b;
}
__device__ __forceinline__ void xcd_barrier_complete(unsigned* bar, unsigned x, unsigned& nloc, unsigned& nx) {
    const unsigned G = gridDim.x * gridDim.y * gridDim.z;
    unsigned sum, cnt, mine, sp = 0u;
    for (;;) {
        sum = 0u; cnt = 0u; mine = 0u;
#pragma unroll
        for (unsigned j = 0; j < 16; ++j) { const unsigned c = xb_ld(&bar[XB_XCNT(j)]); sum += c; cnt += (c > 0u) ? 1u : 0u; mine = (j == x) ? c : mine; }
        if (sum == G) break;
        __builtin_amdgcn_s_sleep(1);
        if ((++sp & 255u) == 0u) { if (xb_ld(&bar[XB_TMO])) break; if (sp > XB_SPIN_CAP) { atomicAdd(&bar[XB_TMO], 1u); break; } }
    }
    nloc = mine > 0u ? mine : 1u; nx = cnt > 0u ? cnt : 1u;
}
__device__ __forceinline__ void xcd_barrier(const XcdBarrier& b) {
    asm volatile("s_waitcnt vmcnt(0)" ::: "memory");
    __syncthreads();
    if (threadIdx.x == 0) {
        unsigned* bar = b.bar;
        __builtin_amdgcn_s_waitcnt(0);
        unsigned nloc = b.st[0], nx = b.st[1];
        if (nloc == 0u) { xcd_barrier_complete(bar, b.x, nloc, nx); b.st[0] = nloc; b.st[1] = nx; }
        const unsigned old = xb_add(&bar[XB_XSUB(b.x)], 1u);
        const unsigned gen = old / nloc;
        if (old + 1u == (gen + 1u) * nloc) {
            __builtin_amdgcn_fence(__ATOMIC_RELEASE, "agent");
            asm volatile("s_waitcnt vmcnt(0)" ::: "memory");
            const unsigned og = xb_add(&bar[XB_TOP], 1u);
            const unsigned tg = og / nx;
            if (og + 1u == (tg + 1u) * nx) xb_add(&bar[XB_TOPGEN], 1u);
            else XB_SPIN(xb_ld(&bar[XB_TOPGEN]) == tg, bar);
            __builtin_amdgcn_fence(__ATOMIC_ACQUIRE, "agent");
            xb_add(&bar[XB_XGEN(b.x)], 1u);
            asm volatile("s_waitcnt vmcnt(0)" ::: "memory");
        } else {
            XB_SPIN(xb_ld(&bar[XB_XGEN(b.x)]) == gen, bar);
            __builtin_amdgcn_fence(__ATOMIC_ACQUIRE, "agent");
            asm volatile("s_waitcnt vmcnt(0)" ::: "memory");
        }
    }
    __syncthreads();
}

namespace pg8 {
constexpr int BM = 256, BK = 64, HALF = 128, HTB = HALF * BK * 2, STAGE_BYTES = 8 * HTB, NXCD = 8, WGM = 8;
__device__ __forceinline__ int lds_byte(int r, int c) { const int st = (r >> 4) * 2 + (c >> 5), rr = r & 15, cc = c & 31, ob = rr * 64 + cc * 2; return st * 1024 + (ob ^ (((ob >> 9) & 1) << 5)); }
__device__ __forceinline__ void stage_rc(int b, int& R, int& C) { const int st = b / 1024, sb = b % 1024, swz = sb ^ (((sb >> 9) & 1) << 5); R = (st >> 1) * 16 + swz / 64; C = (st & 1) * 32 + (swz % 64) / 2; }
struct Unit { int pm, pn, e, mt; };
struct StaticOrder {
    int nM, nN, nwg, G, c;
    __device__ void init(int M, int N, int G_, int c_) { nM = M / BM; nN = N / BM; nwg = nM * nN; G = G_; c = c_; }
    __device__ bool next(int i, Unit& u) const {
        const long L = (long)i * G + c; if (L >= nwg) return false;
        int wgid = (int)L; { const int q = nwg / NXCD, r = nwg % NXCD, xcd = wgid % NXCD, off = wgid / NXCD; wgid = (xcd < r ? xcd * (q + 1) : r * (q + 1) + (xcd - r) * q) + off; }
        const int nig = WGM * nN, gid = wgid / nig, fm = gid * WGM, gsz = (nM - fm) < WGM ? (nM - fm) : WGM;
        u.pm = fm + ((wgid % nig) % gsz); u.pn = (wgid % nig) / gsz; u.e = 0; u.mt = 0; return true;
    }
};

template <class P>
__device__ __forceinline__ void gemm_phase(LAS unsigned char* lds, const P& S) {
    const int tid = threadIdx.x, wid = __builtin_amdgcn_readfirstlane(tid >> 6), lane = tid & 63, wr = wid >> 2, wc = wid & 3, fr = lane & 15, fq = lane >> 4;
    const int K = S.K, nt = K / BK;
    Unit cur, nxt; int ui = 0;
    if (!S.next(0, cur)) return;
    f32x4 acc[2][2][4][2];
#pragma unroll
    for (int a = 0; a < 2; ++a)
#pragma unroll
        for (int b = 0; b < 2; ++b)
#pragma unroll
            for (int m = 0; m < 4; ++m)
#pragma unroll
                for (int n = 0; n < 2; ++n) acc[a][b][m][n] = (f32x4){0.f, 0.f, 0.f, 0.f};
#if NAIVE_GEMM
    for (;;) {
        const bf16_t* Bp = (const bf16_t*)S.bbase(cur);
#pragma unroll 1
        for (int ai = 0; ai < 2; ++ai)
#pragma unroll 1
            for (int m = 0; m < 4; ++m) {
                const bf16_t* Ap = (const bf16_t*)(S.abase() + S.arow_off(cur, ai * 128 + wr * 64 + m * 16 + fr));
#pragma unroll 1
                for (int bj = 0; bj < 2; ++bj)
#pragma unroll 1
                    for (int n = 0; n < 2; ++n) {
                        f32x4 r = (f32x4){0.f, 0.f, 0.f, 0.f};
#pragma unroll 1
                        for (int j = 0; j < 4; ++j) {
                            const bf16_t* Bq = Bp + (size_t)(bj * 128 + wc * 32 + n * 16 + fq * 4 + j) * K; float s = 0.f;
                            for (int k = 0; k < K; ++k) s += bf2f(Ap[k]) * bf2f(Bq[k]);
                            r[j] = s; }
                        acc[ai][bj][m][n] = r; }
            }
        S.epi(acc, cur, wr, wc, fr, fq);
        if (!S.next(++ui, nxt)) break;
        cur = nxt;
    }
    return;
#else
    int sR[2], sC[2]; unsigned voffB[2];
#pragma unroll
    for (int i = 0; i < 2; ++i) { stage_rc(tid * 16 + i * 8192, sR[i], sC[i]); voffB[i] = (unsigned)(sR[i] * K + sC[i]) * 2u; }
    const size_t kstep = (size_t)(BK * 2);
    const size_t hstep = (size_t)HALF * K * 2;
    const unsigned ldsw = (unsigned)wid * 1024u;
    const int aoff = lds_byte(wr * 64 + fr, fq * 8), boff = lds_byte(wc * 32 + fr, fq * 8);
#define PG8_SA(b, h) (((b) * 2 + (h)) * HTB)
#define PG8_SB(b, h) ((4 + (b) * 2 + (h)) * HTB)
#define PG8_STAGE(bufoff, gbase, voff) do { _Pragma("unroll") for (int _i = 0; _i < 2; ++_i) \
        __builtin_amdgcn_global_load_lds((const unsigned*)((const char*)(gbase) + (voff)[_i]), (LAS unsigned*)(lds + (bufoff) + ldsw + _i * 8192), 16, 0, 0); } while (0)
#define PG8_LDA(dst, b, h) do { _Pragma("unroll") for (int m = 0; m < 4; ++m) _Pragma("unroll") for (int k = 0; k < 2; ++k) dst[m][k] = *(const LAS bf16x8*)(lds + PG8_SA(b, h) + aoff + m * 2048 + k * 1024); } while (0)
#define PG8_LDB(dst, b, h) do { _Pragma("unroll") for (int n = 0; n < 2; ++n) _Pragma("unroll") for (int k = 0; k < 2; ++k) dst[n][k] = *(const LAS bf16x8*)(lds + PG8_SB(b, h) + boff + n * 2048 + k * 1024); } while (0)
#define PG8_MMA(ai, bj, At, Bt) do { __builtin_amdgcn_s_setprio(1); _Pragma("unroll") for (int m = 0; m < 4; ++m) _Pragma("unroll") for (int n = 0; n < 2; ++n) _Pragma("unroll") for (int k = 0; k < 2; ++k) \
        acc[ai][bj][m][n] = __builtin_amdgcn_mfma_f32_16x16x32_bf16(Bt[n][k], At[m][k], acc[ai][bj][m][n], 0, 0, 0); __builtin_amdgcn_s_setprio(0); } while (0)
#define PG8_WAIT_V(n) asm volatile("s_waitcnt vmcnt(" #n ")" ::: "memory")
#define PG8_WAIT_L(n) asm volatile("s_waitcnt lgkmcnt(" #n ")" ::: "memory")
#define PG8_BAR __builtin_amdgcn_s_barrier()
#define PG8_SCHED __builtin_amdgcn_sched_barrier(0)
    bf16x8 At[4][2], B0[2][2], B1[2][2];
    unsigned ao0[2], ao1[2], no0[2], no1[2];
#pragma unroll
    for (int i = 0; i < 2; ++i) { ao0[i] = S.arow_off(cur, sR[i]) + (unsigned)sC[i] * 2u; ao1[i] = S.arow_off(cur, HALF + sR[i]) + (unsigned)sC[i] * 2u; }
    const char* const cA = S.abase();
    const char* cB = S.bbase(cur);
    PG8_STAGE(PG8_SB(0, 0), cB, voffB); PG8_STAGE(PG8_SB(0, 1), cB + hstep, voffB); PG8_STAGE(PG8_SA(0, 0), cA, ao0); PG8_STAGE(PG8_SA(0, 1), cA, ao1);
    if (wr == 1) PG8_BAR;
    PG8_WAIT_V(2); PG8_BAR;
    PG8_STAGE(PG8_SB(1, 0), cB + kstep, voffB); PG8_STAGE(PG8_SA(1, 0), cA + kstep, ao0); PG8_STAGE(PG8_SB(1, 1), cB + hstep + kstep, voffB);
    PG8_WAIT_V(6); PG8_BAR;
    for (;;) {
        const bool has_next = S.next(ui + 1, nxt);
        const char* nB = has_next ? S.bbase(nxt) : cB;
        if (has_next) {
#pragma unroll
            for (int i = 0; i < 2; ++i) { no0[i] = S.arow_off(nxt, sR[i]) + (unsigned)sC[i] * 2u; no1[i] = S.arow_off(nxt, HALF + sR[i]) + (unsigned)sC[i] * 2u; }
        } else {
#pragma unroll
            for (int i = 0; i < 2; ++i) { no0[i] = ao0[i]; no1[i] = ao1[i]; }
        }
        for (int t = 0; t < nt; t += 2) {
            const bool last = (t == nt - 2);
            const char* a1 = cA + (size_t)(t + 1) * kstep;
            const char* a2 = last ? cA : cA + (size_t)(t + 2) * kstep; const char* b2 = last ? nB : cB + (size_t)(t + 2) * kstep;
            const char* a3 = a2 + kstep; const char* b3 = b2 + kstep;
            unsigned o20[2], o21[2];
#pragma unroll
            for (int i = 0; i < 2; ++i) { o20[i] = last ? no0[i] : ao0[i]; o21[i] = last ? no1[i] : ao1[i]; }
            PG8_LDB(B0, 0, 0); PG8_LDB(B1, 0, 1); PG8_SCHED; PG8_LDA(At, 0, 0); PG8_STAGE(PG8_SA(1, 1), a1, ao1);
            PG8_WAIT_V(8); PG8_WAIT_L(0); PG8_BAR; PG8_MMA(0, 0, At, B0); PG8_MMA(0, 1, At, B1); PG8_BAR; PG8_SCHED;
            PG8_LDA(At, 0, 1); PG8_STAGE(PG8_SB(0, 0), b2, voffB); PG8_STAGE(PG8_SB(0, 1), b2 + hstep, voffB); PG8_STAGE(PG8_SA(0, 0), a2, o20);
            PG8_WAIT_V(8); PG8_WAIT_L(0); PG8_BAR; PG8_MMA(1, 0, At, B0); PG8_MMA(1, 1, At, B1); PG8_BAR; PG8_SCHED;
            PG8_LDB(B0, 1, 0); PG8_LDB(B1, 1, 1); PG8_SCHED; PG8_LDA(At, 1, 0); PG8_STAGE(PG8_SA(0, 1), a2, o21);
            PG8_WAIT_V(8); PG8_WAIT_L(0); PG8_BAR; PG8_MMA(0, 0, At, B0); PG8_MMA(0, 1, At, B1); PG8_BAR; PG8_SCHED;
            PG8_LDA(At, 1, 1); PG8_STAGE(PG8_SB(1, 0), b3, voffB); PG8_STAGE(PG8_SB(1, 1), b3 + hstep, voffB); PG8_STAGE(PG8_SA(1, 0), a3, o20);
            PG8_WAIT_V(8); PG8_WAIT_L(0); PG8_BAR; PG8_MMA(1, 0, At, B0); PG8_MMA(1, 1, At, B1); PG8_BAR; PG8_SCHED;
        }
        if constexpr (P::ALIGN) { if (wr == 0) PG8_BAR; }
        { int fr_ = fr, fq_ = fq; asm volatile("" : "+v"(fr_), "+v"(fq_));
          S.epi(acc, cur, wr, wc, fr_, fq_); }
        if (!has_next) break;
#pragma unroll
        for (int a = 0; a < 2; ++a)
#pragma unroll
            for (int b = 0; b < 2; ++b)
#pragma unroll
                for (int m = 0; m < 4; ++m)
#pragma unroll
                    for (int n = 0; n < 2; ++n) acc[a][b][m][n] = (f32x4){0.f, 0.f, 0.f, 0.f};
        cur = nxt; cB = nB; ++ui;
#pragma unroll
        for (int i = 0; i < 2; ++i) { ao0[i] = no0[i]; ao1[i] = no1[i]; }
        if constexpr (P::ALIGN) { if (wr == 1) PG8_BAR; }
    }
    PG8_WAIT_V(0);
    if constexpr (!P::ALIGN) { if (wr == 0) PG8_BAR; }
    PG8_BAR;
#undef PG8_SA
#undef PG8_SB
#undef PG8_STAGE
#undef PG8_LDA
#undef PG8_LDB
#undef PG8_MMA
#undef PG8_WAIT_V
#undef PG8_WAIT_L
#undef PG8_BAR
#undef PG8_SCHED
#endif
}
}

struct Args { const float* in[24]; float* out; unsigned char* ws; };
enum { I_X = 0, I_C, I_WADA, I_BADA, I_GMIX, I_WIN, I_CONVW, I_CONVB, I_CLNG, I_CLNB, I_SLNG, I_SLNB, I_SGUW, I_SGUB, I_WOUT, I_GFFN, I_WCO, I_BCO, I_WFI, I_BFI, I_WGATE, I_WUP, I_WDOWN, I_GFIN };

struct Frame {
    LAS unsigned char* lds;
    int tid, lane, wave, G, bid, gw, NGW;
    unsigned char* ws;
};
#define PHASE_FRESH(F) do { asm volatile("" : "+v"((F).tid), "+v"((F).lane)); } while (0)

__device__ __forceinline__ int perm32(int x) { return 8 * ((x >> 2) & 3) + 4 * (x >> 4) + (x & 3); }

__device__ __forceinline__ void transpose_item(const float* colptr, int ld, bf16_t* WT, int K, int p0, int k0, LAS float* scr, int lane) {
#pragma unroll 8
    for (int kk = 0; kk < 64; ++kk) scr[kk * 65 + lane] = colptr[(size_t)(k0 + kk) * ld];
    LDS_WAIT(); asm volatile("" ::: "memory");
    const int c = lane & 7;
#pragma unroll
    for (int jj = 0; jj < 8; ++jj) {
        const int r = (lane >> 3) + 8 * jj; const LAS float* s = scr + (8 * c) * 65 + r;
        u32x4 o; o.x = pk2(s[0], s[65]); o.y = pk2(s[2 * 65], s[3 * 65]); o.z = pk2(s[4 * 65], s[5 * 65]); o.w = pk2(s[6 * 65], s[7 * 65]);
        *(GAS u32x4*)(WT + (size_t)(p0 + r) * K + k0 + 8 * c) = o;
    }
    LDS_WAIT(); asm volatile("" ::: "memory");
}
__device__ __forceinline__ int win_srccol(int p) {
    const int pn = p >> 8, cc = p & 255, bj = cc >> 7, wc = (cc >> 5) & 3, L = perm32(cc & 31);
    if (pn < 4) { const int ch = 128 * pn + 32 * wc + L; return bj ? 512 + ch : ch; }
    if (pn < 6) return 1024 + 256 * (pn - 4) + 128 * bj + 32 * wc + L;
    return 1536 + 64 * (4 * (pn - 6) + wc) + 32 * bj + L;
}
__device__ __forceinline__ void p0_phase(const Args& A, Frame& F) {
    PHASE_FRESH(F);
    LAS float* scr = (LAS float*)(F.lds + F.wave * 16640);
    const int lane = F.lane;
    constexpr int NI_MOD = 96 * 32, NI_WIN = 32 * 16, NI_WOUT = 16 * 16, NI_WGU = 32 * 8 * 16, NI_WD = 32 * 16 * 4, NI_SGUW = 256, NI_WR = 192;
    constexpr int NITEMS = NI_MOD + NI_WIN + NI_WOUT + NI_WGU + NI_WD + NI_SGUW + NI_WR;
    for (int it = F.gw; it < NITEMS; it += F.NGW) {
        int r = it;
        if (r < NI_MOD) {
            const int ng = r % 96, ks = r / 96, n = ng * 64 + lane;
            const float cv = A.in[I_C][(lane >> 5) * 1024 + ks * 32 + (lane & 31)];
            const float sv = cv / (1.0f + __expf(-cv));
            float a0 = 0.f, a1 = 0.f;
            const float* wp = A.in[I_WADA] + (size_t)(ks * 32) * NMOD + n;
#pragma unroll
            for (int kk = 0; kk < 32; ++kk) { const float w = wp[(size_t)kk * NMOD]; a0 += __shfl(sv, kk) * w; a1 += __shfl(sv, 32 + kk) * w; }
            float* modp = (float*)(F.ws + WS_MODP);
            modp[(size_t)(ks * 2 + 0) * NMOD + n] = a0; modp[(size_t)(ks * 2 + 1) * NMOD + n] = a1;
            continue; }
        r -= NI_MOD;
        if (r < NI_WIN) { const int pb = r >> 4, kb = r & 15, p0 = pb * 64;
            transpose_item(A.in[I_WIN] + win_srccol(p0 + lane), 2048, (bf16_t*)(F.ws + WS_WIN), 1024, p0, kb * 64, scr, lane); continue; }
        r -= NI_WIN;
        if (r < NI_WOUT) { const int pb = r >> 4, kb = r & 15, p0 = pb * 64;
            transpose_item(A.in[I_WOUT] + p0 + lane, 1024, (bf16_t*)(F.ws + WS_WOUT), 1024, p0, kb * 64, scr, lane); continue; }
        r -= NI_WOUT;
        if (r < NI_WGU) { const int e = r >> 7, pb = (r >> 4) & 7, kb = r & 15, p0 = pb * 64, p = p0 + lane;
            const int pn = p >> 8, cc = p & 255, bj = cc >> 7, wc = (cc >> 5) & 3, ch = 128 * pn + 32 * wc + perm32(cc & 31);
            const float* src = (bj ? A.in[I_WUP] : A.in[I_WGATE]) + (size_t)e * 1024 * 256 + ch;
            transpose_item(src, 256, (bf16_t*)(F.ws + WS_WGU) + (size_t)e * 512 * 1024, 1024, p0, kb * 64, scr, lane); continue; }
        r -= NI_WGU;
        if (r < NI_WD) { const int e = r >> 6, pb = (r >> 2) & 15, kb = r & 3, p0 = pb * 64, p = p0 + lane;
            const int pn = p >> 8, cc = p & 255, bj = cc >> 7, wc = (cc >> 5) & 3, col = 256 * pn + 128 * bj + 32 * wc + perm32(cc & 31);
            transpose_item(A.in[I_WDOWN] + (size_t)e * 256 * 1024 + col, 1024, (bf16_t*)(F.ws + WS_WD) + (size_t)e * 1024 * 256, 256, p0, kb * 64, scr, lane); continue; }
        r -= NI_WD;
        if (r < NI_SGUW) {
            const int idx = (r * 64 + lane) * 8, s0 = idx & 127, t = (idx >> 7) & 127;
            const f32x4 v0 = *(const f32x4*)(A.in[I_SGUW] + idx), v1 = *(const f32x4*)(A.in[I_SGUW] + idx + 4);
            float v[8] = {v0[0], v0[1], v0[2], v0[3], v1[0], v1[1], v1[2], v1[3]};
#pragma unroll
            for (int j = 0; j < 8; ++j) v[j] = (s0 + j <= t) ? v[j] : 0.f;
            u32x4 o; o.x = pk2(v[0], v[1]); o.y = pk2(v[2], v[3]); o.z = pk2(v[4], v[5]); o.w = pk2(v[6], v[7]);
            *(u32x4*)((bf16_t*)(F.ws + WS_SGUW) + idx) = o; continue; }
        r -= NI_SGUW;
        {
            const int li = r * 64 + lane, lp = li & 63, hl = (li >> 6) & 1, nts = li >> 7, ntile = nts % 3, s = nts / 3;
            const int n = lp & 15, q = lp >> 4, col = 16 * ntile + n;
            float v[8];
#pragma unroll
            for (int j = 0; j < 8; ++j) { const int k = 32 * s + 8 * q + j; float w = 0.f;
                if (col < 4) w = A.in[I_WCO][k * 4 + col]; else if (col < 36) w = A.in[I_WFI][(size_t)((col - 4) >> 3) * 8192 + k * 8 + ((col - 4) & 7)];
                const float hi = bf2f(f2bf(w)); v[j] = hl ? (w - hi) : w; }
            u32x4 o; o.x = pk2(v[0], v[1]); o.y = pk2(v[2], v[3]); o.z = pk2(v[4], v[5]); o.w = pk2(v[6], v[7]);
            *(u32x4*)(F.ws + WS_WR + (size_t)li * 16) = o; }
    }
}

__device__ __forceinline__ void p1_phase(const Args& A, Frame& F) {
    PHASE_FRESH(F);
    LAS float* SCL = (LAS float*)F.lds;
    LAS float* SHF = SCL + 2048;
    const float* modp = (const float*)(F.ws + WS_MODP);
    for (int v = F.tid; v < 4096; v += NWAVES * 64) {
        const int b = v >> 11, n = v & 2047; float s = A.in[I_BADA][n];
#pragma unroll 8
        for (int ks = 0; ks < 32; ++ks) s += modp[(size_t)(ks * 2 + b) * NMOD + n];
        if (n < 1024) SHF[b * 1024 + n] = s; else SCL[b * 1024 + (n - 1024)] = A.in[I_GMIX][n - 1024] * (1.0f + s);
    }
    float* modf = (float*)(F.ws + WS_MODF);
    for (int idx = F.bid * (NWAVES * 64) + F.tid; idx < 2 * NMOD; idx += F.G * NWAVES * 64) {
        const int b = idx / NMOD, n = idx % NMOD; float s = A.in[I_BADA][n];
#pragma unroll 8
        for (int ks = 0; ks < 32; ++ks) s += modp[(size_t)(ks * 2 + b) * NMOD + n];
        modf[idx] = s;
    }
    __syncthreads();
    bf16_t* H = (bf16_t*)(F.ws + WS_H);
    for (int m = F.gw; m < T; m += F.NGW) {
        const int b = m >> 13;
        const GAS f32x4* xr = (const GAS f32x4*)(A.in[I_X] + (size_t)m * D) + F.lane;
        f32x4 v[4]; float s = 0.f;
#pragma unroll
        for (int j = 0; j < 4; ++j) { v[j] = xr[64 * j]; s += (v[j][0] * v[j][0] + v[j][1] * v[j][1]) + (v[j][2] * v[j][2] + v[j][3] * v[j][3]); }
        const float rstd = frsq(wave_sum(s) * (1.0f / D) + EPS);
        GAS u32x2* o8 = (GAS u32x2*)(H + (size_t)m * D) + F.lane;
#pragma unroll
        for (int j = 0; j < 4; ++j) {
            const f32x4 sc = *(const LAS f32x4*)(SCL + b * 1024 + 256 * j + 4 * F.lane), sh = *(const LAS f32x4*)(SHF + b * 1024 + 256 * j + 4 * F.lane);
            const f32x4 h = v[j] * rstd * sc + sh;
            u32x2 o; o.x = pk2(h[0], h[1]); o.y = pk2(h[2], h[3]); o8[64 * j] = o; }
    }
}

struct G1 {
    static constexpr bool ALIGN = true;
    int K; pg8::StaticOrder ord; const char* A_; const char* Bt; bf16_t *yglu, *ug, *vln; const float *lng, *lnb;
    __device__ __forceinline__ bool next(int i, pg8::Unit& u) const { return ord.next(i, u); }
    __device__ __forceinline__ unsigned arow_off(const pg8::Unit& u, int r) const { return (unsigned)(u.pm * 256 + r) * 2048u; }
    __device__ __forceinline__ const char* abase() const { return A_; }
    __device__ __forceinline__ const char* bbase(const pg8::Unit& u) const { return Bt + (size_t)u.pn * 256 * 2048; }
    __device__ __forceinline__ void epi(const f32x4 (&acc)[2][2][4][2], const pg8::Unit& u, int wr, int wc, int fr, int fq) const {
        const int row0 = u.pm * 256 + wr * 64 + fr;
        if (u.pn < 4) {
            const int col = u.pn * 128 + wc * 32 + 8 * fq;
#pragma unroll
            for (int ai = 0; ai < 2; ++ai)
#pragma unroll
                for (int m = 0; m < 4; ++m) {
                    const f32x4 a0 = acc[ai][0][m][0], a1 = acc[ai][0][m][1], g0 = acc[ai][1][m][0], g1 = acc[ai][1][m][1];
                    u32x4 w; w.x = pk2(a0[0] * sigmoid_(g0[0]), a0[1] * sigmoid_(g0[1])); w.y = pk2(a0[2] * sigmoid_(g0[2]), a0[3] * sigmoid_(g0[3]));
                    w.z = pk2(a1[0] * sigmoid_(g1[0]), a1[1] * sigmoid_(g1[1])); w.w = pk2(a1[2] * sigmoid_(g1[2]), a1[3] * sigmoid_(g1[3]));
                    *(u32x4*)(yglu + (size_t)(row0 + ai * 128 + m * 16) * 512 + col) = w; }
        } else if (u.pn < 6) {
#pragma unroll
            for (int ai = 0; ai < 2; ++ai)
#pragma unroll
                for (int m = 0; m < 4; ++m)
#pragma unroll
                    for (int bj = 0; bj < 2; ++bj) {
                        const f32x4 v0 = acc[ai][bj][m][0], v1 = acc[ai][bj][m][1];
                        u32x4 w; w.x = pk2(gelu_tanh_(v0[0]), gelu_tanh_(v0[1])); w.y = pk2(gelu_tanh_(v0[2]), gelu_tanh_(v0[3]));
                        w.z = pk2(gelu_tanh_(v1[0]), gelu_tanh_(v1[1])); w.w = pk2(gelu_tanh_(v1[2]), gelu_tanh_(v1[3]));
                        *(u32x4*)(ug + (size_t)(row0 + ai * 128 + m * 16) * 512 + (u.pn - 4) * 256 + bj * 128 + wc * 32 + 8 * fq) = w; }
        } else {
            const int head = 4 * (u.pn - 6) + wc;
            f32x4 gg[2][2], bb[2][2];
#pragma unroll
            for (int bj = 0; bj < 2; ++bj)
#pragma unroll
                for (int n = 0; n < 2; ++n) { gg[bj][n] = *(const f32x4*)(lng + head * 64 + 32 * bj + 8 * fq + 4 * n); bb[bj][n] = *(const f32x4*)(lnb + head * 64 + 32 * bj + 8 * fq + 4 * n); }
#pragma unroll
            for (int ai = 0; ai < 2; ++ai)
#pragma unroll
                for (int m = 0; m < 4; ++m) {
                    f32x4 v[2][2]; float s = 0.f;
#pragma unroll
                    for (int bj = 0; bj < 2; ++bj)
#pragma unroll
                        for (int n = 0; n < 2; ++n) { const f32x4 a = acc[ai][bj][m][n]; f32x4 g; g[0] = gelu_tanh_(a[0]); g[1] = gelu_tanh_(a[1]); g[2] = gelu_tanh_(a[2]); g[3] = gelu_tanh_(a[3]); v[bj][n] = g; s += (g[0] + g[1]) + (g[2] + g[3]); }
                    s += __shfl_xor(s, 16); s += __shfl_xor(s, 32);
                    const float mean = s * (1.0f / 64.0f); float q = 0.f;
#pragma unroll
                    for (int bj = 0; bj < 2; ++bj)
#pragma unroll
                        for (int n = 0; n < 2; ++n) { v[bj][n] = v[bj][n] - mean; const f32x4 d = v[bj][n]; q += (d[0] * d[0] + d[1] * d[1]) + (d[2] * d[2] + d[3] * d[3]); }
                    q += __shfl_xor(q, 16); q += __shfl_xor(q, 32);
                    const float rstd = frsq(q * (1.0f / 64.0f) + EPS);
#pragma unroll
                    for (int bj = 0; bj < 2; ++bj) {
                        const f32x4 y0 = v[bj][0] * rstd * gg[bj][0] + bb[bj][0], y1 = v[bj][1] * rstd * gg[bj][1] + bb[bj][1];
                        u32x4 w; w.x = pk2(y0[0], y0[1]); w.y = pk2(y0[2], y0[3]); w.z = pk2(y1[0], y1[1]); w.w = pk2(y1[2], y1[3]);
                        *(u32x4*)(vln + (size_t)(row0 + ai * 128 + m * 16) * 512 + head * 64 + 32 * bj + 8 * fq) = w; }
                }
        }
    }
};

__device__ __forceinline__ void conv_item(const Args& A, Frame& F, int item) {
    const int lane = F.lane, strip = item >> 2, cb = item & 3;
    const int t0 = strip * 32, p0 = t0 & (SEQ - 1);
    const int cp = cb * 64 + lane;
    const unsigned* yin = (const unsigned*)(F.ws + WS_YGLU);
    unsigned* yout = (unsigned*)(F.ws + WS_YMIX);
    float w0[31], w1[31];
#pragma unroll
    for (int k = 0; k < 31; ++k) { const f32x2 w = *(const f32x2*)(A.in[I_CONVW] + k * 512 + 2 * cp); w0[k] = w[0]; w1[k] = w[1]; }
    const f32x2 bb = *(const f32x2*)(A.in[I_CONVB] + 2 * cp);
    float a0[32], a1[32];
#pragma unroll
    for (int r = 0; r < 32; ++r) { a0[r] = bb[0]; a1[r] = bb[1]; }
#pragma unroll
    for (int j = 0; j < 62; ++j) {
        unsigned pk = 0u;
        if (p0 + j >= 30) pk = yin[(size_t)(t0 - 30 + j) * 256 + cp];
        const float x0 = __uint_as_float(pk << 16), x1 = __uint_as_float(pk & 0xffff0000u);
#pragma unroll
        for (int r = (j > 30 ? j - 30 : 0); r <= (j < 31 ? j : 31); ++r) { a0[r] += w0[j - r] * x0; a1[r] += w1[j - r] * x1; }
    }
    const f32x2 lg = *(const f32x2*)(A.in[I_CLNG] + 2 * cp), lb = *(const f32x2*)(A.in[I_CLNB] + 2 * cp);
#pragma unroll
    for (int r = 0; r < 32; ++r) {
        float s = a0[r] + a1[r];
#pragma unroll
        for (int o = 1; o < 32; o <<= 1) s += __shfl_xor(s, o);
        const float mean = s * (1.0f / 64.0f), d0 = a0[r] - mean, d1 = a1[r] - mean;
        float q = d0 * d0 + d1 * d1;
#pragma unroll
        for (int o = 1; o < 32; o <<= 1) q += __shfl_xor(q, o);
        const float rstd = frsq(q * (1.0f / 64.0f) + EPS);
        yout[(size_t)(t0 + r) * 512 + cp] = pk2(silu_(d0 * rstd * lg[0] + lb[0]), silu_(d1 * rstd * lg[1] + lb[1]));
    }
}
__device__ __forceinline__ void sgu_item(const Args& A, Frame& F, int item) {
    const int lane = F.lane, ch = item >> 3, h = item & 7, row0 = ch * 128;
    constexpr int LDT = 136;
    LAS bf16_t* VT = (LAS bf16_t*)(F.lds + F.wave * 17408);
    const bf16_t* vln = (const bf16_t*)(F.ws + WS_VLN);
#pragma unroll
    for (int half = 0; half < 2; ++half) {
        const int s = lane + 64 * half;
        const u32x4* src = (const u32x4*)(vln + (size_t)(row0 + s) * 512 + h * 64);
#pragma unroll
        for (int c8 = 0; c8 < 8; ++c8) {
            const u32x4 v = src[c8];
#pragma unroll
            for (int i = 0; i < 4; ++i) { VT[(8 * c8 + 2 * i) * LDT + s] = (bf16_t)(v[i] & 0xffffu); VT[(8 * c8 + 2 * i + 1) * LDT + s] = (bf16_t)(v[i] >> 16); }
        }
    }
    LDS_WAIT(); asm volatile("" ::: "memory");
    const int dl = lane & 15, q = lane >> 4;
    bf16x8 vt[4][4];
#pragma unroll
    for (int dt = 0; dt < 4; ++dt)
#pragma unroll
        for (int ks = 0; ks < 4; ++ks) vt[dt][ks] = *(const LAS bf16x8*)(VT + (16 * dt + dl) * LDT + 32 * ks + 8 * q);
    const bf16_t* W = (const bf16_t*)(F.ws + WS_SGUW) + h * 16384;
    const bf16_t* ug = (const bf16_t*)(F.ws + WS_UG);
    bf16_t* ymix = (bf16_t*)(F.ws + WS_YMIX);
#pragma unroll
    for (int i = 0; i < 8; ++i) {
        f32x4 acc[4];
#pragma unroll
        for (int dt = 0; dt < 4; ++dt) acc[dt] = (f32x4){0.f, 0.f, 0.f, 0.f};
#pragma unroll
        for (int ks = 0; ks <= (i >> 1); ++ks) {
            const bf16x8 wf = *(const bf16x8*)(W + (16 * i + dl) * 128 + 32 * ks + 8 * q);
#pragma unroll
            for (int dt = 0; dt < 4; ++dt) acc[dt] = __builtin_amdgcn_mfma_f32_16x16x32_bf16(vt[dt][ks], wf, acc[dt], 0, 0, 0);
        }
        const int t = 16 * i + dl;
        const float bias = A.in[I_SGUB][h * 128 + t];
#pragma unroll
        for (int dt = 0; dt < 4; ++dt) {
            const u32x2 uu = *(const u32x2*)(ug + (size_t)(row0 + t) * 512 + h * 64 + 16 * dt + 4 * q);
            const float u0 = __uint_as_float(uu.x << 16), u1 = __uint_as_float(uu.x & 0xffff0000u), u2 = __uint_as_float(uu.y << 16), u3 = __uint_as_float(uu.y & 0xffff0000u);
            u32x2 o; o.x = pk2(u0 * (acc[dt][0] + bias), u1 * (acc[dt][1] + bias)); o.y = pk2(u2 * (acc[dt][2] + bias), u3 * (acc[dt][3] + bias));
            *(u32x2*)(ymix + (size_t)(row0 + t) * 1024 + 512 + h * 64 + 16 * dt + 4 * q) = o; }
    }
    LDS_WAIT(); asm volatile("" ::: "memory");
}
__device__ __forceinline__ void p3_phase(const Args& A, Frame& F) {
    PHASE_FRESH(F);
    for (int it = F.gw; it < 2048; it += F.NGW) conv_item(A, F, it);
    for (int it = F.gw; it < 2048; it += F.NGW) if ((it & 1) == 0) sgu_item(A, F, it >> 1);
}

struct G2 {
    static constexpr bool ALIGN = false;
    int K; pg8::StaticOrder ord; const char* A_; const char* Bt; const float* x; float* out; const float* modf; float* sumsq;
    __device__ __forceinline__ bool next(int i, pg8::Unit& u) const { return ord.next(i, u); }
    __device__ __forceinline__ unsigned arow_off(const pg8::Unit& u, int r) const { return (unsigned)(u.pm * 256 + r) * 2048u; }
    __device__ __forceinline__ const char* abase() const { return A_; }
    __device__ __forceinline__ const char* bbase(const pg8::Unit& u) const { return Bt + (size_t)u.pn * 256 * 2048; }
    __device__ __forceinline__ void epi(const f32x4 (&acc)[2][2][4][2], const pg8::Unit& u, int wr, int wc, int fr, int fq) const {
        const int row0 = u.pm * 256 + wr * 64 + fr, col0 = u.pn * 256 + wc * 32 + 4 * fq, b = (u.pm * 256) >> 13;
        f32x4 gt[2][2];
#pragma unroll
        for (int bj = 0; bj < 2; ++bj)
#pragma unroll
            for (int n = 0; n < 2; ++n) gt[bj][n] = *(const f32x4*)(modf + b * NMOD + 2048 + col0 + bj * 128 + n * 16);
#pragma unroll
        for (int ai = 0; ai < 2; ++ai)
#pragma unroll
            for (int m = 0; m < 4; ++m) {
                const int row = row0 + ai * 128 + m * 16; float s = 0.f;
#pragma unroll
                for (int bj = 0; bj < 2; ++bj)
#pragma unroll
                    for (int n = 0; n < 2; ++n) {
                        const size_t off = (size_t)row * D + col0 + bj * 128 + n * 16;
                        const f32x4 o = *(const f32x4*)(x + off) + gt[bj][n] * acc[ai][bj][m][n];
                        *(f32x4*)(out + off) = o; s += (o[0] * o[0] + o[1] * o[1]) + (o[2] * o[2] + o[3] * o[3]); }
                s += __shfl_xor(s, 16); s += __shfl_xor(s, 32);
                if (fq == 0) sumsq[(size_t)row * 16 + 4 * u.pn + wc] = s;
            }
    }
};

__device__ __forceinline__ void p5_phase(const Args& A, Frame& F) {
    PHASE_FRESH(F);
    LAS float* SC2 = (LAS float*)F.lds;
    LAS float* SH2 = SC2 + 2048;
    LAS float* LG = (LAS float*)(F.lds + 16384) + F.wave * (16 * 52);
    LAS int* CNT = (LAS int*)(F.lds + 49152);
    LAS int* BASE = CNT + 32;
    LAS int* PE = (LAS int*)(F.lds + 49152 + 256);
    const float* modf = (const float*)(F.ws + WS_MODF);
    for (int v = F.tid; v < 2048; v += NWAVES * 64) { const int b = v >> 10, k = v & 1023;
        SC2[v] = A.in[I_GFFN][k] * (1.0f + modf[b * NMOD + 4096 + k]); SH2[v] = modf[b * NMOD + 3072 + k]; }
    if (F.tid < 32) CNT[F.tid] = 0;
    for (int v = F.tid; v < 256; v += NWAVES * 64) PE[v * 4 + 1] = -1;
    __syncthreads();
    const int lane = F.lane, r = lane & 15, q = lane >> 4;
    const int gi = F.wave * F.G + F.bid;
    if (gi < T / 16) {
        const int m0 = gi * 16, row = m0 + r, b = m0 >> 13;
        const float* x1 = A.out + (size_t)row * D;
        bf16_t* h2 = (bf16_t*)(F.ws + WS_H) + (size_t)row * D;
        const f32x4 sq = *(const f32x4*)((const float*)(F.ws + WS_SUMSQ) + (size_t)row * 16 + 4 * q);
        float ss = (sq[0] + sq[1]) + (sq[2] + sq[3]); ss += __shfl_xor(ss, 16); ss += __shfl_xor(ss, 32);
        const float rstd = frsq(ss * (1.0f / D) + EPS);
        f32x4 acc[3];
#pragma unroll
        for (int n = 0; n < 3; ++n) acc[n] = (f32x4){0.f, 0.f, 0.f, 0.f};
        const u32x4* WRf = (const u32x4*)(F.ws + WS_WR) + lane;
#pragma unroll 2
        for (int s = 0; s < 32; ++s) {
            const int k0 = 32 * s + 8 * q;
            const f32x4 xa = *(const f32x4*)(x1 + k0), xb = *(const f32x4*)(x1 + k0 + 4);
            const f32x4 sa = *(const LAS f32x4*)(SC2 + b * 1024 + k0), sb = *(const LAS f32x4*)(SC2 + b * 1024 + k0 + 4);
            const f32x4 ha = *(const LAS f32x4*)(SH2 + b * 1024 + k0), hb = *(const LAS f32x4*)(SH2 + b * 1024 + k0 + 4);
            const f32x4 va = xa * rstd * sa + ha, vb = xb * rstd * sb + hb;
            u32x4 hi; hi.x = pk2(va[0], va[1]); hi.y = pk2(va[2], va[3]); hi.z = pk2(vb[0], vb[1]); hi.w = pk2(vb[2], vb[3]);
            *(u32x4*)(h2 + k0) = hi;
            u32x4 lo;
            lo.x = pk2(va[0] - __uint_as_float(hi.x << 16), va[1] - __uint_as_float(hi.x & 0xffff0000u)); lo.y = pk2(va[2] - __uint_as_float(hi.y << 16), va[3] - __uint_as_float(hi.y & 0xffff0000u));
            lo.z = pk2(vb[0] - __uint_as_float(hi.z << 16), vb[1] - __uint_as_float(hi.z & 0xffff0000u)); lo.w = pk2(vb[2] - __uint_as_float(hi.w << 16), vb[3] - __uint_as_float(hi.w & 0xffff0000u));
            const bf16x8 ahi = __builtin_bit_cast(bf16x8, hi), alo = __builtin_bit_cast(bf16x8, lo);
#pragma unroll
            for (int n = 0; n < 3; ++n) {
                const bf16x8 whi = __builtin_bit_cast(bf16x8, WRf[((s * 3 + n) * 2 + 0) * 64]), wlo = __builtin_bit_cast(bf16x8, WRf[((s * 3 + n) * 2 + 1) * 64]);
                acc[n] = __builtin_amdgcn_mfma_f32_16x16x32_bf16(whi, ahi, acc[n], 0, 0, 0);
                acc[n] = __builtin_amdgcn_mfma_f32_16x16x32_bf16(whi, alo, acc[n], 0, 0, 0);
                acc[n] = __builtin_amdgcn_mfma_f32_16x16x32_bf16(wlo, ahi, acc[n], 0, 0, 0);
            }
        }
#pragma unroll
        for (int n = 0; n < 3; ++n) *(LAS f32x4*)(LG + r * 52 + 16 * n + 4 * q) = acc[n];
        LDS_WAIT(); asm volatile("" ::: "memory");
        if (lane < 16) {
            const LAS float* lg = LG + lane * 52;
            float c[4]; int grp = 0; float cmax;
#pragma unroll
            for (int i = 0; i < 4; ++i) c[i] = lg[i] + A.in[I_BCO][i];
            cmax = c[0];
#pragma unroll
            for (int i = 1; i < 4; ++i) if (c[i] > cmax) { cmax = c[i]; grp = i; }
            float den = 0.f;
#pragma unroll
            for (int i = 0; i < 4; ++i) den += __expf(c[i] - cmax);
            const float pgrp = 1.0f / den;
            float f[8];
#pragma unroll
            for (int i = 0; i < 8; ++i) f[i] = lg[4 + grp * 8 + i] + A.in[I_BFI][grp * 8 + i];
            int i1 = 0; float f1 = f[0];
#pragma unroll
            for (int i = 1; i < 8; ++i) if (f[i] > f1) { f1 = f[i]; i1 = i; }
            int i2 = -1; float f2 = -3.0e38f;
#pragma unroll
            for (int i = 0; i < 8; ++i) if (i != i1 && f[i] > f2) { f2 = f[i]; i2 = i; }
            const float g1 = 1.0f / (1.0f + __expf(f2 - f1)), g2 = 1.0f - g1;
            const int e1 = grp * 8 + i1, e2 = grp * 8 + i2, lrow = F.wave * 16 + lane;
            const int l1 = atomicAdd((int*)&CNT[e1], 1), l2 = atomicAdd((int*)&CNT[e2], 1);
            PE[(lrow * 2) * 4 + 0] = m0 + lane; PE[(lrow * 2) * 4 + 1] = e1; PE[(lrow * 2) * 4 + 2] = l1; PE[(lrow * 2) * 4 + 3] = (int)__float_as_uint(pgrp * g1);
            PE[(lrow * 2 + 1) * 4 + 0] = m0 + lane; PE[(lrow * 2 + 1) * 4 + 1] = e2; PE[(lrow * 2 + 1) * 4 + 2] = l2; PE[(lrow * 2 + 1) * 4 + 3] = (int)__float_as_uint(pgrp * g2);
        }
    }
    __syncthreads();
    if (F.tid < 32) { const int n = CNT[F.tid]; BASE[F.tid] = n ? (int)atomicAdd((unsigned*)(F.ws + WS_CTL) + CW_ECNT + 64 * F.tid, (unsigned)n) : 0; }
    __syncthreads();
    for (int v = F.tid; v < 256; v += NWAVES * 64) {
        const int e = PE[v * 4 + 1];
        if (e >= 0) { const int tok = PE[v * 4 + 0], slot = BASE[e] + PE[v * 4 + 2];
            ((int*)(F.ws + WS_TOKL))[(size_t)e * T + slot] = tok; ((unsigned*)(F.ws + WS_GATEL))[(size_t)e * T + slot] = (unsigned)PE[v * 4 + 3];
            int* rt = (int*)(F.ws + WS_ROUTE) + (size_t)tok * 4 + (v & 1) * 2; rt[0] = e; rt[1] = slot; }
    }
}

struct GE {
    const LAS int* ecnt; const LAS int* tbase; int G, c;
    template <int LOGN> __device__ __forceinline__ bool decode(int i, pg8::Unit& u) const {
        const int L = i * G + c, ti = L >> LOGN; const int total = tbase[32];
        if (ti >= total) return false;
        int e = 0;
        while (tbase[e + 1] <= ti) ++e;
        e = __builtin_amdgcn_readfirstlane(e);
        u.pm = ti; u.pn = L & ((1 << LOGN) - 1); u.e = e; u.mt = __builtin_amdgcn_readfirstlane(ti - tbase[e]); return true;
    }
};
struct G6 {
    static constexpr bool ALIGN = true;
    int K; GE ge; const char* A_; const char* Bt; const int* tokl; bf16_t* hid;
    __device__ __forceinline__ bool next(int i, pg8::Unit& u) const { return ge.decode<1>(i, u); }
    __device__ __forceinline__ unsigned arow_off(const pg8::Unit& u, int r) const {
        const int idx = u.mt * 256 + r; int tok = 0;
        if (idx < ge.ecnt[u.e]) tok = tokl[(size_t)u.e * T + idx];
        return (unsigned)tok * 2048u; }
    __device__ __forceinline__ const char* abase() const { return A_; }
    __device__ __forceinline__ const char* bbase(const pg8::Unit& u) const { return Bt + ((size_t)u.e * 512 + (size_t)u.pn * 256) * 2048; }
    __device__ __forceinline__ void epi(const f32x4 (&acc)[2][2][4][2], const pg8::Unit& u, int wr, int wc, int fr, int fq) const {
        const int row0 = u.pm * 256 + wr * 64 + fr, col = u.pn * 128 + wc * 32 + 8 * fq;
#pragma unroll
        for (int ai = 0; ai < 2; ++ai)
#pragma unroll
            for (int m = 0; m < 4; ++m) {
                const f32x4 g0 = acc[ai][0][m][0], g1 = acc[ai][0][m][1], u0 = acc[ai][1][m][0], u1 = acc[ai][1][m][1];
                u32x4 w; w.x = pk2(silu_(g0[0]) * u0[0], silu_(g0[1]) * u0[1]); w.y = pk2(silu_(g0[2]) * u0[2], silu_(g0[3]) * u0[3]);
                w.z = pk2(silu_(g1[0]) * u1[0], silu_(g1[1]) * u1[1]); w.w = pk2(silu_(g1[2]) * u1[2], silu_(g1[3]) * u1[3]);
                *(u32x4*)(hid + (size_t)(row0 + ai * 128 + m * 16) * 256 + col) = w; }
    }
};
struct G7 {
    static constexpr bool ALIGN = true;
    int K; GE ge; const char* A_; const char* Bt; const float* gatel; bf16_t* ypair;
    __device__ __forceinline__ bool next(int i, pg8::Unit& u) const { return ge.decode<2>(i, u); }
    __device__ __forceinline__ unsigned arow_off(const pg8::Unit& u, int r) const { return (unsigned)(u.pm * 256 + r) * 512u; }
    __device__ __forceinline__ const char* abase() const { return A_; }
    __device__ __forceinline__ const char* bbase(const pg8::Unit& u) const { return Bt + ((size_t)u.e * 1024 + (size_t)u.pn * 256) * 512; }
    __device__ __forceinline__ void epi(const f32x4 (&acc)[2][2][4][2], const pg8::Unit& u, int wr, int wc, int fr, int fq) const {
        const int r0 = wr * 64 + fr;
#pragma unroll
        for (int ai = 0; ai < 2; ++ai)
#pragma unroll
            for (int m = 0; m < 4; ++m) {
                const int r = r0 + ai * 128 + m * 16;
                const float g = gatel[(size_t)u.e * T + u.mt * 256 + r];
#pragma unroll
                for (int bj = 0; bj < 2; ++bj) {
                    const f32x4 v0 = acc[ai][bj][m][0] * g, v1 = acc[ai][bj][m][1] * g;
                    u32x4 w; w.x = pk2(v0[0], v0[1]); w.y = pk2(v0[2], v0[3]); w.z = pk2(v1[0], v1[1]); w.w = pk2(v1[2], v1[3]);
                    *(u32x4*)(ypair + (size_t)(u.pm * 256 + r) * 1024 + u.pn * 256 + bj * 128 + wc * 32 + 8 * fq) = w; }
            }
    }
};

__device__ __forceinline__ void p8_phase(const Args& A, Frame& F, const LAS int* tbase) {
    PHASE_FRESH(F);
    LAS float* GT2 = (LAS float*)F.lds;
    LAS float* GF = GT2 + 2048;
    const float* modf = (const float*)(F.ws + WS_MODF);
    for (int v = F.tid; v < 2048; v += NWAVES * 64) GT2[v] = modf[(v >> 10) * NMOD + 5120 + (v & 1023)];
    for (int v = F.tid; v < 1024; v += NWAVES * 64) GF[v] = A.in[I_GFIN][v];
    __syncthreads();
    const bf16_t* yp = (const bf16_t*)(F.ws + WS_YPAIR);
    for (int m = F.gw; m < T; m += F.NGW) {
        const int b = m >> 13;
        const int* rt = (const int*)(F.ws + WS_ROUTE) + (size_t)m * 4;
        const int e1 = __builtin_amdgcn_readfirstlane(rt[0]), s1 = __builtin_amdgcn_readfirstlane(rt[1]), e2 = __builtin_amdgcn_readfirstlane(rt[2]), s2 = __builtin_amdgcn_readfirstlane(rt[3]);
        const size_t ra = (size_t)(tbase[e1] * 256 + s1), rb = (size_t)(tbase[e2] * 256 + s2);
        GAS f32x4* xr = (GAS f32x4*)(A.out + (size_t)m * D) + F.lane;
        const GAS u32x2* pa = (const GAS u32x2*)(yp + ra * D) + F.lane;
        const GAS u32x2* pb = (const GAS u32x2*)(yp + rb * D) + F.lane;
        f32x4 v[4]; float s = 0.f;
#pragma unroll
        for (int j = 0; j < 4; ++j) {
            const f32x4 xv = xr[64 * j]; const u32x2 ya = pa[64 * j], yb = pb[64 * j];
            const f32x4 gt = *(const LAS f32x4*)(GT2 + b * 1024 + 256 * j + 4 * F.lane);
            f32x4 y; y[0] = __uint_as_float(ya.x << 16) + __uint_as_float(yb.x << 16); y[1] = __uint_as_float(ya.x & 0xffff0000u) + __uint_as_float(yb.x & 0xffff0000u);
            y[2] = __uint_as_float(ya.y << 16) + __uint_as_float(yb.y << 16); y[3] = __uint_as_float(ya.y & 0xffff0000u) + __uint_as_float(yb.y & 0xffff0000u);
            v[j] = xv + gt * y; s += (v[j][0] * v[j][0] + v[j][1] * v[j][1]) + (v[j][2] * v[j][2] + v[j][3] * v[j][3]); }
        const float rstd = frsq(wave_sum(s) * (1.0f / D) + EPS);
#pragma unroll
        for (int j = 0; j < 4; ++j) xr[64 * j] = v[j] * rstd * *(const LAS f32x4*)(GF + 256 * j + 4 * F.lane);
    }
}

__global__ void __launch_bounds__(NWAVES * 64, 2) fwd_kernel(Args args) {
    extern __shared__ __attribute__((aligned(16))) unsigned char lds[];
    Frame F;
    F.lds = (LAS unsigned char*)lds;
    F.tid = threadIdx.x; F.lane = F.tid & 63; F.wave = __builtin_amdgcn_readfirstlane(F.tid >> 6);
    F.G = gridDim.x; F.bid = blockIdx.x; F.gw = F.bid * NWAVES + F.wave; F.NGW = F.G * NWAVES; F.ws = args.ws;
    LAS int* LCTL = (LAS int*)(F.lds + LDSCTL_OFF);
    for (int u = F.tid; u < (LDS_BYTES - LDSCTL_OFF) / 4; u += NWAVES * 64) LCTL[u] = 0;
    __syncthreads();
    unsigned* ctl = (unsigned*)(F.ws + WS_CTL);
    XcdBarrier bar = xcd_barrier_post(ctl + CW_BAR, (volatile LAS unsigned*)(LCTL + LC_BAR));
    LAS int* ECNT = LCTL + LC_ECNT; LAS int* TBASE = LCTL + LC_TBASE;

    p0_phase(args, F);
    xcd_barrier(bar);
    p1_phase(args, F);
    xcd_barrier(bar);
    {
        G1 g; g.K = 1024; g.ord.init(T, 2048, F.G, F.bid); g.A_ = (const char*)(F.ws + WS_H); g.Bt = (const char*)(F.ws + WS_WIN);
        g.yglu = (bf16_t*)(F.ws + WS_YGLU); g.ug = (bf16_t*)(F.ws + WS_UG); g.vln = (bf16_t*)(F.ws + WS_VLN); g.lng = args.in[I_SLNG]; g.lnb = args.in[I_SLNB];
        pg8::gemm_phase<G1>(F.lds, g);
    }
    xcd_barrier(bar);
    p3_phase(args, F);
    xcd_barrier(bar);
    {
        G2 g; g.K = 1024; g.ord.init(T, 1024, F.G, F.bid); g.A_ = (const char*)(F.ws + WS_YMIX); g.Bt = (const char*)(F.ws + WS_WOUT);
        g.x = args.in[I_X]; g.out = args.out; g.modf = (const float*)(F.ws + WS_MODF); g.sumsq = (float*)(F.ws + WS_SUMSQ);
        pg8::gemm_phase<G2>(F.lds, g);
    }
    xcd_barrier(bar);
    p5_phase(args, F);
    xcd_barrier(bar);
    if (F.tid < 32) ECNT[F.tid] = (int)__hip_atomic_load(ctl + CW_ECNT + 64 * F.tid, RLX_AGENT);
    __syncthreads();
    if (F.tid == 0) { int acc = 0; for (int e = 0; e < 32; ++e) { TBASE[e] = acc; acc += (ECNT[e] + 255) >> 8; } TBASE[32] = acc; }
    __syncthreads();
    {
        G6 g; g.K = 1024; g.ge.ecnt = ECNT; g.ge.tbase = TBASE; g.ge.G = F.G; g.ge.c = F.bid; g.A_ = (const char*)(F.ws + WS_H); g.Bt = (const char*)(F.ws + WS_WGU);
        g.tokl = (const int*)(F.ws + WS_TOKL); g.hid = (bf16_t*)(F.ws + WS_HID);
        pg8::gemm_phase<G6>(F.lds, g);
    }
    xcd_barrier(bar);
    {
        G7 g; g.K = 256; g.ge.ecnt = ECNT; g.ge.tbase = TBASE; g.ge.G = F.G; g.ge.c = F.bid; g.A_ = (const char*)(F.ws + WS_HID); g.Bt = (const char*)(F.ws + WS_WD);
        g.gatel = (const float*)(F.ws + WS_GATEL); g.ypair = (bf16_t*)(F.ws + WS_YPAIR);
        pg8::gemm_phase<G7>(F.lds, g);
    }
    xcd_barrier(bar);
    p8_phase(args, F, TBASE);
}

extern "C" void kernel_launch(void* const* d_in, const int* in_sizes, int n_in, void* d_out, int out_size, void* d_ws, size_t ws_size, hipStream_t stream) {
    static int grid = 0;
    if (grid == 0) {
        if (n_in != 24 || out_size != T * D || ws_size < WS_END) { fprintf(stderr, "kernel_launch: unexpected shapes (n_in %d out %d ws %zu)\n", n_in, out_size, ws_size); grid = -1; return; }
        int dev = 0, cus = 0, per_cu = 0;
        if (hipGetDevice(&dev) != hipSuccess || hipDeviceGetAttribute(&cus, hipDeviceAttributeMultiprocessorCount, dev) != hipSuccess) { grid = -1; return; }
        if (hipFuncSetAttribute((const void*)fwd_kernel, hipFuncAttributeMaxDynamicSharedMemorySize, LDS_BYTES) != hipSuccess) { fprintf(stderr, "kernel_launch: hipFuncSetAttribute failed\n"); grid = -1; return; }
        if (hipOccupancyMaxActiveBlocksPerMultiprocessor(&per_cu, (const void*)fwd_kernel, NWAVES * 64, LDS_BYTES) != hipSuccess || per_cu < 1)
            fprintf(stderr, "kernel_launch: note: occupancy query reports %d\n", per_cu);
        (void)hipGetLastError();
        grid = cus;
        if (grid > 256) grid = 256;
    }
    if (grid < 0) return;
    if (hipMemsetAsync((char*)d_ws + WS_CTL, 0, CTL_ZERO_BYTES, stream) != hipSuccess) return;
    Args a{};
    for (int i = 0; i < 24; ++i) a.in[i] = (const float*)d_in[i];
    a.out = (float*)d_out; a.ws = (unsigned char*)d_ws;
    hipLaunchKernelGGL(fwd_kernel, dim3(grid), dim3(NWAVES * 64), LDS_BYTES, stream, a);
}
```
